# Optimizing an MI355X kernel written in HIP

```python
import math
import jax, jax.numpy as jnp
from jax import lax
import numpy as np

D_MODEL = 1024
BATCH = 4
SEQ = 8192
DEPTH = 1

ATTN_WIDTH = D_MODEL // 2
CONV_WIDTH = D_MODEL - ATTN_WIDTH
HEAD_DIM = 64
N_HEADS = ATTN_WIDTH // HEAD_DIM
CONV_GROUPS = 8
MOBA_BLOCK = 256
MOBA_TOPK = 3
QUERY_CHUNK = 32
CONV_K = 3
D_FF = 256 * math.ceil(8 * D_MODEL / 3 / 256)
IN_COLS = 3 * ATTN_WIDTH + 3 * CONV_WIDTH
RMS_EPS = 1e-6
NEG_BIG = -1e30

kernel_name = "hymba_moba_shortconv_convffn_adaln"


def rmsnorm(x, g):
    xf = x.astype(jnp.float32)
    y = xf * lax.rsqrt(jnp.mean(xf * xf, axis=-1, keepdims=True) + RMS_EPS)
    return (y * g.astype(jnp.float32)).astype(x.dtype)


def causal_dwconv(x, w, b):
    K = w.shape[0]
    S = x.shape[1]
    xp = jnp.pad(x, ((0, 0), (K - 1, 0), (0, 0)))
    y = xp[:, 0:S] * w[0]
    for kk in range(1, K):
        y = y + xp[:, kk:kk + S] * w[kk]
    return y + b


def alibi_slopes(n_heads):
    return 2.0 ** (-8.0 * jnp.arange(1, n_heads + 1, dtype=jnp.float32) / n_heads)


def moba_attention(q, k, v, slopes):
    B, H, S, dh = q.shape
    nb = -(-S // MOBA_BLOCK)
    s_pad = nb * MOBA_BLOCK
    pad = ((0, 0), (0, 0), (0, s_pad - S), (0, 0))
    k_blocks = jnp.pad(k, pad).reshape(B, H, nb, MOBA_BLOCK, dh)
    v_blocks = jnp.pad(v, pad).reshape(B, H, nb, MOBA_BLOCK, dh)
    k_mean = jnp.mean(k_blocks.astype(jnp.float32), axis=3)
    n_sel = min(MOBA_TOPK, nb)
    scale = dh ** -0.5
    n_chunks = S // QUERY_CHUNK
    bi = jnp.arange(B)[:, None, None, None]
    hi = jnp.arange(H)[None, :, None, None]
    blk_pos = jnp.arange(MOBA_BLOCK)

    def one_chunk(ci):
        start = ci * QUERY_CHUNK
        qc = lax.dynamic_slice_in_dim(q, start, QUERY_CHUNK, axis=2).astype(jnp.float32)
        t = start + jnp.arange(QUERY_CHUNK)
        blk = start // MOBA_BLOCK
        gate = jnp.einsum('bhqd,bhnd->bhqn', qc, k_mean)
        gate = jnp.where(jnp.arange(nb) < blk, gate, NEG_BIG)
        _, idx = lax.top_k(gate, n_sel)
        sel_ok = idx < blk
        ks = k_blocks[bi, hi, idx].astype(jnp.float32)
        vs = v_blocks[bi, hi, idx].astype(jnp.float32)
        s_sel = jnp.einsum('bhqd,bhqnkd->bhqnk', qc, ks) * scale
        pos_sel = idx[..., None] * MOBA_BLOCK + blk_pos
        dist_sel = (t[None, None, :, None, None] - pos_sel).astype(jnp.float32)
        s_sel = s_sel - slopes[None, :, None, None, None] * dist_sel
        s_sel = jnp.where(sel_ok[..., None], s_sel, NEG_BIG)
        k_own = lax.dynamic_index_in_dim(k_blocks, blk, axis=2, keepdims=False).astype(jnp.float32)
        v_own = lax.dynamic_index_in_dim(v_blocks, blk, axis=2, keepdims=False).astype(jnp.float32)
        s_own = jnp.einsum('bhqd,bhkd->bhqk', qc, k_own) * scale
        dist_own = (t[:, None] - (blk * MOBA_BLOCK + blk_pos)[None, :]).astype(jnp.float32)
        s_own = s_own - slopes[None, :, None, None] * dist_own
        s_own = jnp.where(dist_own >= 0, s_own, NEG_BIG)
        scores = jnp.concatenate(
            [s_sel.reshape(B, H, QUERY_CHUNK, n_sel * MOBA_BLOCK), s_own], axis=-1)
        p = jax.nn.softmax(scores, axis=-1)
        p_sel = p[..., :n_sel * MOBA_BLOCK].reshape(B, H, QUERY_CHUNK, n_sel, MOBA_BLOCK)
        p_own = p[..., n_sel * MOBA_BLOCK:]
        out = (jnp.einsum('bhqnk,bhqnkd->bhqd', p_sel, vs)
               + jnp.einsum('bhqk,bhkd->bhqd', p_own, v_own))
        return out.astype(q.dtype)

    outs = lax.map(one_chunk, jnp.arange(n_chunks))
    return outs.transpose(1, 2, 0, 3, 4).reshape(B, H, S, dh)


def setup_inputs(seed: int = 0) -> dict:
    key = jax.random.key(seed)
    ks = jax.random.split(key, 20)
    f32 = jnp.float32

    def nrm(k, shape, scale):
        return jax.random.normal(k, shape, f32) * scale

    L = DEPTH
    return {
        "x": nrm(ks[0], (BATCH, SEQ, D_MODEL), 1.0),
        "c": nrm(ks[1], (BATCH, D_MODEL), 1.0),
        "w_ada": nrm(ks[2], (L, D_MODEL, 6 * D_MODEL), 0.5 * D_MODEL ** -0.5),
        "b_ada": nrm(ks[3], (L, 6 * D_MODEL), 0.01),
        "g_mix": 1.0 + nrm(ks[4], (L, D_MODEL), 0.02),
        "w_in": nrm(ks[5], (L, D_MODEL, IN_COLS), D_MODEL ** -0.5),
        "conv_w": nrm(ks[6], (L, CONV_K, CONV_WIDTH), CONV_K ** -0.5),
        "conv_b": nrm(ks[7], (L, CONV_WIDTH), 0.01),
        "g_attn_out": 1.0 + nrm(ks[8], (L, ATTN_WIDTH), 0.02),
        "g_conv_out": 1.0 + nrm(ks[9], (L, CONV_WIDTH), 0.02),
        "w_out": nrm(ks[10], (L, D_MODEL, D_MODEL), D_MODEL ** -0.5),
        "g_ffn": 1.0 + nrm(ks[11], (L, D_MODEL), 0.02),
        "w_up": nrm(ks[12], (L, D_MODEL, 2 * D_FF), D_MODEL ** -0.5),
        "ffn_conv_w": nrm(ks[13], (L, CONV_K, 2 * D_FF), CONV_K ** -0.5),
        "ffn_conv_b": nrm(ks[14], (L, 2 * D_FF), 0.01),
        "w_down": nrm(ks[15], (L, D_FF, D_MODEL), D_FF ** -0.5),
        "g_final": 1.0 + nrm(ks[16], (D_MODEL,), 0.02),
    }


def reference(x, c, w_ada, b_ada, g_mix, w_in, conv_w, conv_b, g_attn_out, g_conv_out,
              w_out, g_ffn, w_up, ffn_conv_w, ffn_conv_b, w_down, g_final):
    B, S, D = x.shape
    slopes = alibi_slopes(N_HEADS)
    A, C = ATTN_WIDTH, CONV_WIDTH
    for l in range(DEPTH):
        mod = (jax.nn.silu(c) @ w_ada[l] + b_ada[l]).astype(x.dtype)
        sh1, sc1, gt1, sh2, sc2, gt2 = jnp.split(mod[:, None, :], 6, axis=-1)

        h = rmsnorm(x, g_mix[l]) * (1.0 + sc1) + sh1
        proj = h @ w_in[l]
        q, k, v, u, c_gate, b_gate = jnp.split(
            proj, [A, 2 * A, 3 * A, 3 * A + C, 3 * A + 2 * C], axis=-1)

        def heads(t):
            return t.reshape(B, S, N_HEADS, HEAD_DIM).transpose(0, 2, 1, 3)

        attn = moba_attention(heads(q), heads(k), heads(v), slopes)
        attn = attn.transpose(0, 2, 1, 3).reshape(B, S, A)
        conv = b_gate * causal_dwconv(c_gate * u, conv_w[l], conv_b[l])
        mixed = jnp.concatenate([rmsnorm(attn, g_attn_out[l]),
                                 rmsnorm(conv, g_conv_out[l])], axis=-1)
        x = x + gt1 * (mixed @ w_out[l])

        h = rmsnorm(x, g_ffn[l]) * (1.0 + sc2) + sh2
        up = causal_dwconv(h @ w_up[l], ffn_conv_w[l], ffn_conv_b[l])
        val, gte = jnp.split(up, 2, axis=-1)
        x = x + gt2 * ((jax.nn.silu(gte) * val) @ w_down[l])
    return rmsnorm(x, g_final)
```

```cpp
#include <hip/hip_runtime.h>
#include <cstdio>
#include <cstdint>

#ifndef MK_N_LAUNCHES
#define MK_N_LAUNCHES 0
#endif

namespace pg8 {
#define PG8_LAS __attribute__((address_space(3)))
typedef unsigned short bf16_t;
typedef short bf16x8 __attribute__((ext_vector_type(8)));
typedef float f32x4 __attribute__((ext_vector_type(4)));
typedef unsigned u32x4 __attribute__((ext_vector_type(4)));
constexpr int BM = 256, BK = 64, HALF = 128, HTB = HALF * BK * 2, STAGE_BYTES = 8 * HTB, NXCD = 8, WGM = 8;

__host__ __device__ __forceinline__ int lds_byte(int r, int c) { const int st = (r >> 4) * 2 + (c >> 5), rr = r & 15, cc = c & 31, ob = rr * 64 + cc * 2; return st * 1024 + (ob ^ (((ob >> 9) & 1) << 5)); }
__host__ __device__ __forceinline__ void stage_rc(int b, int& R, int& C) { const int st = b / 1024, sb = b % 1024, swz = sb ^ (((sb >> 9) & 1) << 5); R = (st >> 1) * 16 + swz / 64; C = (st & 1) * 32 + (swz % 64) / 2; }
__host__ __device__ __forceinline__ int perm32(int rho) { const int n = rho >> 4, i = rho & 15; return 8 * (i >> 2) + 4 * n + (i & 3); }

struct Unit { int pm, pn; };
struct Gemm { const bf16_t* A; const bf16_t* Bt; int M, N, K; };

struct StaticOrder {
    int nM, nN, nwg, G, c;
    __host__ __device__ void init(int M, int N, int G_, int c_) { nM = M / BM; nN = N / BM; nwg = nM * nN; G = G_; c = c_; }
    __host__ __device__ bool next(int i, Unit& u) const {
        const long L = (long)i * G + c; if (L >= nwg) return false;
        int wgid = (int)L; { const int q = nwg / NXCD, r = nwg % NXCD, xcd = wgid % NXCD, off = wgid / NXCD; wgid = (xcd < r ? xcd * (q + 1) : r * (q + 1) + (xcd - r) * q) + off; }
        const int nig = WGM * nN, gid = wgid / nig, fm = gid * WGM, gsz = (nM - fm) < WGM ? (nM - fm) : WGM;
        u.pm = fm + ((wgid % nig) % gsz); u.pn = (wgid % nig) / gsz; return true;
    }
    __device__ __forceinline__ void a_ready(const Unit&) const {}
    __device__ __forceinline__ void done(const Unit&) const {}
};

__device__ __forceinline__ unsigned cvt_pk_bf16(float lo, float hi) { unsigned r; asm volatile("v_cvt_pk_bf16_f32 %0, %1, %2" : "=v"(r) : "v"(lo), "v"(hi)); return r; }

struct EpiBf16 {
    static constexpr bool PERM = true, AFTER_DRAIN = false;
    bf16_t* O; int ldc; int split_cols; size_t split_stride; float scale0;
    __device__ __forceinline__ void operator()(const f32x4 (&acc)[2][2][4][2], const Unit& u, int wr, int wc, int fr, int fq) const {
        const int row0 = u.pm * BM + wr * 64 + fr; int colt = u.pn * BM; bf16_t* base = O;
        float sc = 1.f; if (split_cols) { const int t = colt / split_cols; base += (size_t)t * split_stride; colt -= t * split_cols; if (t == 0) sc = scale0; }
        const int col0 = colt + wc * 32 + 8 * fq;
#pragma unroll
        for (int ai = 0; ai < 2; ++ai)
#pragma unroll
            for (int m = 0; m < 4; ++m) { bf16_t* rowp = base + (size_t)(row0 + ai * HALF + m * 16) * ldc + col0;
#pragma unroll
                for (int bj = 0; bj < 2; ++bj) { f32x4 v0 = acc[ai][bj][m][0] * sc, v1 = acc[ai][bj][m][1] * sc;
                    u32x4 w; w.x = cvt_pk_bf16(v0[0], v0[1]); w.y = cvt_pk_bf16(v0[2], v0[3]); w.z = cvt_pk_bf16(v1[0], v1[1]); w.w = cvt_pk_bf16(v1[2], v1[3]);
                    *(u32x4*)(rowp + bj * HALF) = w; } }
    }
};
struct EpiRes {
    static constexpr bool PERM = false, AFTER_DRAIN = false;
    const float* base; float* out; const float* gate; int ldc;
    __device__ __forceinline__ void operator()(const f32x4 (&acc)[2][2][4][2], const Unit& u, int wr, int wc, int fr, int fq) const {
        const int col0 = u.pn * BM + wc * 32 + 4 * fq;
#pragma unroll
        for (int ai = 0; ai < 2; ++ai)
#pragma unroll
            for (int m = 0; m < 4; ++m) { const int row = u.pm * BM + ai * HALF + wr * 64 + m * 16 + fr; const float* gp = gate + (size_t)(row >> 13) * 6144 + col0; const size_t off = (size_t)row * ldc + col0;
#pragma unroll
                for (int bj = 0; bj < 2; ++bj)
#pragma unroll
                    for (int n = 0; n < 2; ++n) { const f32x4 g = *(const f32x4*)(gp + bj * HALF + n * 16); const f32x4 bs = *(const f32x4*)(base + off + bj * HALF + n * 16);
                        *(f32x4*)(out + off + bj * HALF + n * 16) = bs + g * acc[ai][bj][m][n]; } }
    }
};

template <class Epi, class Sched, bool ALIGN_EPI = false, bool SP2 = false>
__device__ __forceinline__ void gemm_phase(PG8_LAS unsigned char* lds, const Gemm g, const Sched& S, const Epi& E) {
    const int tid = threadIdx.x, wid = __builtin_amdgcn_readfirstlane(tid >> 6), lane = tid & 63, wr = wid >> 2, wc = wid & 3, fr = lane & 15, fq = lane >> 4;
    const int K = g.K, nt = K / BK;
    unsigned voffA[2], voffB[2];
#pragma unroll
    for (int i = 0; i < 2; ++i) { int R, C; stage_rc(tid * 16 + i * 8192, R, C); const int Rb = Epi::PERM ? ((R & ~31) + perm32(R & 31)) : R;
        voffA[i] = (unsigned)(R * K + C) * 2u; voffB[i] = (unsigned)(Rb * K + C) * 2u; }
    const size_t kstep = (size_t)(BK * 2);
    const size_t hstep = (size_t)HALF * K * 2;
    const size_t tstep = 2 * hstep;
    const unsigned ldsw = (unsigned)wid * 1024u;
    const int aoff = lds_byte(wr * 64 + fr, fq * 8), boff = lds_byte(wc * 32 + fr, fq * 8);
#define PG8_SA(b, h) (((b) * 2 + (h)) * HTB)
#define PG8_SB(b, h) ((4 + (b) * 2 + (h)) * HTB)
#define PG8_STAGE(bufoff, gbase, voff) do { _Pragma("unroll") for (int _i = 0; _i < 2; ++_i) \
        __builtin_amdgcn_global_load_lds((const unsigned*)((const char*)(gbase) + (voff)[_i]), (PG8_LAS unsigned*)(lds + (bufoff) + ldsw + _i * 8192), 16, 0, 0); } while (0)
#define PG8_LDA(dst, b, h) do { _Pragma("unroll") for (int m = 0; m < 4; ++m) _Pragma("unroll") for (int k = 0; k < 2; ++k) dst[m][k] = *(const PG8_LAS bf16x8*)(lds + PG8_SA(b, h) + aoff + m * 2048 + k * 1024); } while (0)
#define PG8_LDB(dst, b, h) do { _Pragma("unroll") for (int n = 0; n < 2; ++n) _Pragma("unroll") for (int k = 0; k < 2; ++k) dst[n][k] = *(const PG8_LAS bf16x8*)(lds + PG8_SB(b, h) + boff + n * 2048 + k * 1024); } while (0)
#define PG8_MMA(ai, bj, At, Bt) do { __builtin_amdgcn_s_setprio(1); _Pragma("unroll") for (int m = 0; m < 4; ++m) _Pragma("unroll") for (int n = 0; n < 2; ++n) _Pragma("unroll") for (int k = 0; k < 2; ++k) \
        acc[ai][bj][m][n] = __builtin_amdgcn_mfma_f32_16x16x32_bf16(Bt[n][k], At[m][k], acc[ai][bj][m][n], 0, 0, 0); __builtin_amdgcn_s_setprio(0); } while (0)
#define PG8_WAIT_V(n) asm volatile("s_waitcnt vmcnt(" #n ")" ::: "memory")
#define PG8_WAIT_L(n) asm volatile("s_waitcnt lgkmcnt(" #n ")" ::: "memory")
#define PG8_BAR __builtin_amdgcn_s_barrier()
#define PG8_SCHED __builtin_amdgcn_sched_barrier(0)
    Unit cur, nxt; int ui = 0;
    if (!S.next(0, cur)) return;
    f32x4 acc[2][2][4][2];
#pragma unroll
    for (int a = 0; a < 2; ++a)
#pragma unroll
        for (int b = 0; b < 2; ++b)
#pragma unroll
            for (int m = 0; m < 4; ++m)
#pragma unroll
                for (int n = 0; n < 2; ++n) acc[a][b][m][n] = (f32x4){0.f, 0.f, 0.f, 0.f};
    bf16x8 At[4][2], B0[2][2], B1[2][2];
    const char* cA = (const char*)g.A + (size_t)cur.pm * tstep; const char* cB = (const char*)g.Bt + (size_t)cur.pn * tstep;
    S.a_ready(cur);
    if constexpr (SP2) {
        PG8_STAGE(PG8_SB(0, 0), cB, voffB); PG8_STAGE(PG8_SB(0, 1), cB + hstep, voffB); PG8_STAGE(PG8_SA(0, 0), cA, voffA); PG8_STAGE(PG8_SA(0, 1), cA + hstep, voffA);
        if (wr == 1) PG8_BAR;
        PG8_WAIT_V(2); PG8_BAR;
        PG8_STAGE(PG8_SB(1, 0), cB + kstep, voffB); PG8_STAGE(PG8_SA(1, 0), cA + kstep, voffA); PG8_STAGE(PG8_SB(1, 1), cB + hstep + kstep, voffB);
        PG8_WAIT_V(6); PG8_BAR;
    } else {
        PG8_STAGE(PG8_SB(0, 0), cB, voffB); PG8_STAGE(PG8_SA(0, 0), cA, voffA); PG8_STAGE(PG8_SB(0, 1), cB + hstep, voffB); PG8_STAGE(PG8_SA(0, 1), cA + hstep, voffA);
        if (wr == 1) PG8_BAR;
        PG8_WAIT_V(4); PG8_BAR;
        PG8_STAGE(PG8_SB(1, 0), cB + kstep, voffB); PG8_STAGE(PG8_SA(1, 0), cA + kstep, voffA); PG8_STAGE(PG8_SB(1, 1), cB + hstep + kstep, voffB);
        PG8_WAIT_V(6); PG8_BAR;
    }
    for (;;) {
        const bool has_next = S.next(ui + 1, nxt);
        const char* nA = has_next ? (const char*)g.A + (size_t)nxt.pm * tstep : cA; const char* nB = has_next ? (const char*)g.Bt + (size_t)nxt.pn * tstep : cB;
        for (int t = 0; t < nt; t += 2) {
            const bool last = (t == nt - 2);
            const char* a1 = cA + (size_t)(t + 1) * kstep;
            const char* a2 = last ? nA : cA + (size_t)(t + 2) * kstep; const char* b2 = last ? nB : cB + (size_t)(t + 2) * kstep;
            const char* a3 = a2 + kstep; const char* b3 = b2 + kstep;
            if (last && has_next) S.a_ready(nxt);
            if constexpr (SP2) {
            PG8_LDB(B0, 0, 0); PG8_LDB(B1, 0, 1); PG8_SCHED; PG8_LDA(At, 0, 0); PG8_STAGE(PG8_SA(1, 1), a1 + hstep, voffA);
            PG8_WAIT_V(8); PG8_WAIT_L(0); PG8_BAR; PG8_MMA(0, 0, At, B0); PG8_MMA(0, 1, At, B1); PG8_BAR; PG8_SCHED;
            PG8_LDA(At, 0, 1); PG8_STAGE(PG8_SB(0, 0), b2, voffB); PG8_STAGE(PG8_SB(0, 1), b2 + hstep, voffB); PG8_STAGE(PG8_SA(0, 0), a2, voffA);
            PG8_WAIT_V(8); PG8_WAIT_L(0); PG8_BAR; PG8_MMA(1, 0, At, B0); PG8_MMA(1, 1, At, B1); PG8_BAR; PG8_SCHED;
            PG8_LDB(B0, 1, 0); PG8_LDB(B1, 1, 1); PG8_SCHED; PG8_LDA(At, 1, 0); PG8_STAGE(PG8_SA(0, 1), a2 + hstep, voffA);
            PG8_WAIT_V(8); PG8_WAIT_L(0); PG8_BAR; PG8_MMA(0, 0, At, B0); PG8_MMA(0, 1, At, B1); PG8_BAR; PG8_SCHED;
            PG8_LDA(At, 1, 1); PG8_STAGE(PG8_SB(1, 0), b3, voffB); PG8_STAGE(PG8_SB(1, 1), b3 + hstep, voffB); PG8_STAGE(PG8_SA(1, 0), a3, voffA);
            PG8_WAIT_V(8); PG8_WAIT_L(0); PG8_BAR; PG8_MMA(1, 0, At, B0); PG8_MMA(1, 1, At, B1); PG8_BAR; PG8_SCHED;
            } else {
            PG8_LDB(B0, 0, 0); PG8_SCHED; PG8_LDA(At, 0, 0); PG8_STAGE(PG8_SA(1, 1), a1 + hstep, voffA);
            PG8_WAIT_L(8); PG8_BAR; PG8_WAIT_L(0); PG8_MMA(0, 0, At, B0); PG8_BAR; PG8_SCHED;
            PG8_LDB(B1, 0, 1); PG8_STAGE(PG8_SB(0, 0), b2, voffB);
            PG8_BAR; PG8_WAIT_L(0); PG8_MMA(0, 1, At, B1); PG8_BAR;
            PG8_LDA(At, 0, 1); PG8_STAGE(PG8_SA(0, 0), a2, voffA);
            PG8_BAR; PG8_WAIT_L(0); PG8_MMA(1, 0, At, B0); PG8_BAR; PG8_SCHED;
            PG8_STAGE(PG8_SB(0, 1), b2 + hstep, voffB);
            PG8_WAIT_V(6); PG8_BAR; PG8_MMA(1, 1, At, B1); PG8_BAR;
            PG8_LDB(B0, 1, 0); PG8_SCHED; PG8_LDA(At, 1, 0); PG8_STAGE(PG8_SA(0, 1), a2 + hstep, voffA);
            PG8_WAIT_L(8); PG8_BAR; PG8_WAIT_L(0); PG8_MMA(0, 0, At, B0); PG8_BAR; PG8_SCHED;
            PG8_LDB(B1, 1, 1); PG8_STAGE(PG8_SB(1, 0), b3, voffB);
            PG8_BAR; PG8_WAIT_L(0); PG8_MMA(0, 1, At, B1); PG8_BAR;
            PG8_LDA(At, 1, 1); PG8_STAGE(PG8_SA(1, 0), a3, voffA);
            PG8_BAR; PG8_WAIT_L(0); PG8_MMA(1, 0, At, B0); PG8_BAR; PG8_SCHED;
            PG8_STAGE(PG8_SB(1, 1), b3 + hstep, voffB);
            PG8_WAIT_V(6); PG8_BAR; PG8_MMA(1, 1, At, B1); PG8_BAR;
            }
        }
        if constexpr (ALIGN_EPI) { if (wr == 0) PG8_BAR; }
        if constexpr (!Epi::AFTER_DRAIN) { E(acc, cur, wr, wc, fr, fq); S.done(cur); }
        if (!has_next) break;
#pragma unroll
        for (int a = 0; a < 2; ++a)
#pragma unroll
            for (int b = 0; b < 2; ++b)
#pragma unroll
                for (int m = 0; m < 4; ++m)
#pragma unroll
                    for (int n = 0; n < 2; ++n) acc[a][b][m][n] = (f32x4){0.f, 0.f, 0.f, 0.f};
        cur = nxt; cA = nA; cB = nB; ++ui;
        if constexpr (ALIGN_EPI) { if (wr == 1) PG8_BAR; }
    }
    PG8_WAIT_V(0);
    if constexpr (!ALIGN_EPI) { if (wr == 0) PG8_BAR; }
    PG8_BAR;
#undef PG8_SA
#undef PG8_SB
#undef PG8_STAGE
#undef PG8_LDA
#undef PG8_LDB
#undef PG8_MMA
#undef PG8_WAIT_V
#undef PG8_WAIT_L
#undef PG8_BAR
#undef PG8_SCHED
}
}

constexpr int NWAVES = 8;
constexpr int BATCH = 4, SEQ = 8192, D = 1024, M = BATCH * SEQ;
constexpr int AW = 512, NH = 8, HD = 64, NBLK = 32, BLK = 256;
constexpr int DFF = 2816, NIN = 3072, NUP = 2 * DFF;
constexpr float RMS_EPS = 1e-6f;
constexpr float LOG2E = 1.4426950408889634f;
constexpr float C2 = 0.125f * LOG2E;
constexpr int NPHASE = 17;

constexpr size_t MiB = 1u << 20;
constexpr size_t WS_CTL = 0, CTL_ZERO_BYTES = 1 * MiB;
constexpr size_t WS_MOD = 1 * MiB;
constexpr size_t WS_KMEAN = 1 * MiB + 128 * 1024;
constexpr size_t WS_SS = 2 * MiB;
constexpr size_t WS_CNT = 3 * MiB;
constexpr size_t WS_TOT = 3 * MiB + 128 * 1024;
constexpr size_t WS_PML = 4 * MiB;
constexpr size_t WS_LBUF = 10 * MiB;
constexpr size_t WS_GLIST = 26 * MiB;
constexpr size_t WS_WIN = 42 * MiB, WS_WOUT = 48 * MiB, WS_WUP = 50 * MiB, WS_WDN = 61 * MiB;
constexpr size_t WS_XN = 68 * MiB;
constexpr size_t WS_Q = 132 * MiB, WS_K = 164 * MiB, WS_V = 196 * MiB, WS_U = 228 * MiB, WS_CG = 260 * MiB, WS_BG = 292 * MiB;
constexpr size_t WS_ATT = 324 * MiB;
constexpr size_t WS_PO = 356 * MiB;
constexpr size_t WS_MIX = 356 * MiB;
constexpr size_t WS_UPH = 132 * MiB;
constexpr size_t WS_ACT = 308 * MiB;
constexpr size_t WS_END = 484 * MiB;
constexpr int CW_TMO = 0;
constexpr int CW_BAR = 4096;

constexpr int RING_OFF = 0, RING_BYTES = 131072;
constexpr int LDSCTL_OFF = RING_BYTES, MISC_OFF = LDSCTL_OFF + 320;
constexpr int LDS_BYTES = 147456;

#define GAS __attribute__((address_space(1)))
#define LAS __attribute__((address_space(3)))
typedef unsigned short bf16;
typedef unsigned v4u __attribute__((ext_vector_type(4)));
typedef unsigned v2u __attribute__((ext_vector_type(2)));
typedef float f32x4 __attribute__((ext_vector_type(4)));
typedef float f32x16 __attribute__((ext_vector_type(16)));
typedef short bf16x8 __attribute__((ext_vector_type(8)));
typedef short s16x4 __attribute__((ext_vector_type(4)));
typedef GAS unsigned gu32;
#define RLX_AGENT __ATOMIC_RELAXED, __HIP_MEMORY_SCOPE_AGENT
#define LDS_WAIT() asm volatile("s_waitcnt lgkmcnt(0)" ::: "memory")
#define VM_WAIT() asm volatile("s_waitcnt vmcnt(0)" ::: "memory")
__device__ __forceinline__ unsigned f2bf(float f) { unsigned u = __builtin_bit_cast(unsigned, f); return (u + 0x7fffu + ((u >> 16) & 1u)) >> 16; }
__device__ __forceinline__ unsigned pk2(float lo, float hi) { return f2bf(lo) | (f2bf(hi) << 16); }
__device__ __forceinline__ float bflo(unsigned w) { return __builtin_bit_cast(float, w << 16); }
__device__ __forceinline__ float bfhi(unsigned w) { return __builtin_bit_cast(float, w & 0xffff0000u); }

#define XB_TMO      128
#define XB_XCNT(j)  (256  + 64 * (j))
#define XB_XSUB(j)  (1280 + 64 * (j))
#define XB_XGEN(j)  (2304 + 64 * (j))
#define XB_TOP      3328
#define XB_TOPGEN   3392
#define XCD_BAR_WORDS 3456
#define XB_SPIN_CAP (1u << 18)
__device__ __forceinline__ unsigned xb_ld(unsigned* p)              { return __hip_atomic_load(p, __ATOMIC_RELAXED, __HIP_MEMORY_SCOPE_AGENT); }
__device__ __forceinline__ unsigned xb_add(unsigned* p, unsigned v) { return __hip_atomic_fetch_add(p, v, __ATOMIC_RELAXED, __HIP_MEMORY_SCOPE_AGENT); }
__device__ __forceinline__ unsigned xb_xcc_id() { return (unsigned)__builtin_amdgcn_s_getreg((3 << 11) | 20) & 0xFu; }
#define XB_SPIN(cond, bar) do { unsigned _sp = 0; while (cond) { __builtin_amdgcn_s_sleep(1); \
    if ((++_sp & 255u) == 0u) { if (xb_ld(&(bar)[XB_TMO])) break; if (_sp > XB_SPIN_CAP) { atomicAdd(&(bar)[XB_TMO], 1u); break; } } } } while (0)
struct XcdBarrier { unsigned* bar; unsigned x; volatile LAS unsigned* st; };
__device__ __forceinline__ XcdBarrier xcd_barrier_post(unsigned* bar, volatile LAS unsigned* st) {
    XcdBarrier b; b.bar = bar; b.x = xb_xcc_id(); b.st = st;
    if (threadIdx.x == 0) (void)xb_add(&bar[XB_XCNT(b.x)], 1u);
    return b;
}
__device__ __forceinline__ void xcd_barrier_complete(unsigned* bar, unsigned x, unsigned& nloc, unsigned& nx) {
    const unsigned G = gridDim.x * gridDim.y * gridDim.z;
    unsigned sum, cnt, mine, sp = 0u;
    for (;;) {
        sum = 0u; cnt = 0u; mine = 0u;
#pragma unroll
        for (unsigned j = 0; j < 16; ++j) { const unsigned c = xb_ld(&bar[XB_XCNT(j)]); sum += c; cnt += (c > 0u) ? 1u : 0u; mine = (j == x) ? c : mine; }
        if (sum == G) break;
        __builtin_amdgcn_s_sleep(1);
        if ((++sp & 255u) == 0u) { if (xb_ld(&bar[XB_TMO])) break; if (sp > XB_SPIN_CAP) { atomicAdd(&bar[XB_TMO], 1u); break; } }
    }
    nloc = mine > 0u ? mine : 1u; nx = cnt > 0u ? cnt : 1u;
}
__device__ __forceinline__ void xcd_barrier(const XcdBarrier& b) {
    asm volatile("s_waitcnt vmcnt(0)" ::: "memory");
    __syncthreads();
    if (threadIdx.x == 0) {
        unsigned* bar = b.bar;
        __builtin_amdgcn_s_waitcnt(0);
        unsigned nloc = b.st[0], nx = b.st[1];
        if (nloc == 0u) { xcd_barrier_complete(bar, b.x, nloc, nx); b.st[0] = nloc; b.st[1] = nx; }
        const unsigned old = xb_add(&bar[XB_XSUB(b.x)], 1u);
        const unsigned gen = old / nloc;
        if (old + 1u == (gen + 1u) * nloc) {
            __builtin_amdgcn_fence(__ATOMIC_RELEASE, "agent");
            asm volatile("s_waitcnt vmcnt(0)" ::: "memory");
            const unsigned og = xb_add(&bar[XB_TOP], 1u);
            const unsigned tg = og / nx;
            if (og + 1u == (tg + 1u) * nx) xb_add(&bar[XB_TOPGEN], 1u);
            else XB_SPIN(xb_ld(&bar[XB_TOPGEN]) == tg, bar);
            __builtin_amdgcn_fence(__ATOMIC_ACQUIRE, "agent");
            xb_add(&bar[XB_XGEN(b.x)], 1u);
            asm volatile("s_waitcnt vmcnt(0)" ::: "memory");
        } else {
            XB_SPIN(xb_ld(&bar[XB_XGEN(b.x)]) == gen, bar);
            __builtin_amdgcn_fence(__ATOMIC_ACQUIRE, "agent");
            asm volatile("s_waitcnt vmcnt(0)" ::: "memory");
        }
    }
    __syncthreads();
}

struct Frame {
    LAS unsigned char* lds;
    volatile LAS unsigned* MISC;
    gu32* ctl;
    int tid, lane, wave;
    int vcu, G;
    unsigned char* ws;
    const float* in[17];
    float* out;
};
__device__ __forceinline__ float wave_sum(float v) {
#pragma unroll
    for (int o = 1; o < 64; o <<= 1) v += __shfl_xor(v, o);
    return v;
}

__device__ __forceinline__ void p0_transpose_item(const float* W, int K, int N, bf16* WT, LAS float* scr, int item, int lane) {
    const int nblk = N / 32, kb = item / nblk, nb = item % nblk, k0 = 64 * kb, n0 = 32 * nb;
#pragma unroll 8
    for (int i = 0; i < 32; ++i) { const int kk = 2 * i + (lane >> 5); scr[kk * 33 + (lane & 31)] = W[(size_t)(k0 + kk) * N + n0 + (lane & 31)]; }
    LDS_WAIT(); asm volatile("" ::: "memory");
    const int c = lane & 7;
#pragma unroll
    for (int j = 0; j < 4; ++j) { const int n = (lane >> 3) + 8 * j; const LAS float* s = scr + (8 * c) * 33 + n;
        v4u o; o.x = pk2(s[0 * 33], s[1 * 33]); o.y = pk2(s[2 * 33], s[3 * 33]); o.z = pk2(s[4 * 33], s[5 * 33]); o.w = pk2(s[6 * 33], s[7 * 33]);
        *(GAS v4u*)(WT + (size_t)(n0 + n) * K + k0 + 8 * c) = o; }
    LDS_WAIT(); asm volatile("" ::: "memory");
}
__device__ __forceinline__ void p0_prologue(Frame& F) {
    if (F.vcu < 96) {
        LAS float* sc = (LAS float*)(F.lds + RING_OFF);
        LAS float* red = (LAS float*)(F.lds + RING_OFF + 16384);
        const float* c = F.in[1];
        for (int i = F.tid; i < 4096; i += 512) { const float v = c[i]; sc[i] = v / (1.f + __expf(-v)); }
        __syncthreads();
        const float* wa = F.in[2]; const int col = F.vcu * 64 + F.lane;
        float a0 = 0.f, a1 = 0.f, a2 = 0.f, a3 = 0.f;
        const int kb = F.wave * 128;
#pragma unroll 8
        for (int k = 0; k < 128; ++k) { const float w = wa[(size_t)(kb + k) * 6144 + col];
            a0 += sc[kb + k] * w; a1 += sc[1024 + kb + k] * w; a2 += sc[2048 + kb + k] * w; a3 += sc[3072 + kb + k] * w; }
        red[(F.wave * 4 + 0) * 64 + F.lane] = a0; red[(F.wave * 4 + 1) * 64 + F.lane] = a1; red[(F.wave * 4 + 2) * 64 + F.lane] = a2; red[(F.wave * 4 + 3) * 64 + F.lane] = a3;
        __syncthreads();
        if (F.tid < 256) { const int b = F.tid >> 6, l = F.tid & 63; float s = 0.f;
#pragma unroll
            for (int w = 0; w < 8; ++w) s += red[(w * 4 + b) * 64 + l];
            ((float*)(F.ws + WS_MOD))[b * 6144 + F.vcu * 64 + l] = s + F.in[3][F.vcu * 64 + l]; }
        __syncthreads();
    }
    LAS float* scr = (LAS float*)(F.lds + RING_OFF + F.wave * 16384);
    const int gw = F.vcu * NWAVES + F.wave, NGW = F.G * NWAVES;
    constexpr int I_IN = (D / 64) * (NIN / 32), I_OUT = (D / 64) * (D / 32), I_UP = (D / 64) * (NUP / 32), I_DN = (DFF / 64) * (D / 32);
    constexpr int NITEMS = I_IN + I_OUT + I_UP + I_DN;
    for (int it = gw; it < NITEMS; it += NGW) {
        int r = it;
        if (r < I_IN) { p0_transpose_item(F.in[5], D, NIN, (bf16*)(F.ws + WS_WIN), scr, r, F.lane); continue; } r -= I_IN;
        if (r < I_OUT) { p0_transpose_item(F.in[10], D, D, (bf16*)(F.ws + WS_WOUT), scr, r, F.lane); continue; } r -= I_OUT;
        if (r < I_UP) { p0_transpose_item(F.in[12], D, NUP, (bf16*)(F.ws + WS_WUP), scr, r, F.lane); continue; } r -= I_UP;
        p0_transpose_item(F.in[15], DFF, D, (bf16*)(F.ws + WS_WDN), scr, r, F.lane);
    }
}
__device__ __forceinline__ void modnorm_phase(Frame& F, const float* src, const float* g, int sh_off, int sc_off, bf16* dst) {
    const int gw = F.vcu * NWAVES + F.wave, NGW = F.G * NWAVES;
    const float* mod = (const float*)(F.ws + WS_MOD);
    for (int ch = gw; ch < M / 16; ch += NGW) {
        const int row0 = ch * 16, b = row0 >> 13;
        f32x4 A[4], B[4];
#pragma unroll
        for (int j = 0; j < 4; ++j) { const int col = 4 * F.lane + 256 * j; const f32x4 gg = *(const f32x4*)(g + col), s = *(const f32x4*)(mod + b * 6144 + sc_off + col);
            A[j] = gg * (s + 1.0f); B[j] = *(const f32x4*)(mod + b * 6144 + sh_off + col); }
        for (int r = 0; r < 16; ++r) {
            const GAS f32x4* xr = (const GAS f32x4*)(src + (size_t)(row0 + r) * D) + F.lane;
            f32x4 v[4]; float s = 0.f;
#pragma unroll
            for (int j = 0; j < 4; ++j) { v[j] = xr[64 * j]; s += (v[j].x * v[j].x + v[j].y * v[j].y) + (v[j].z * v[j].z + v[j].w * v[j].w); }
            const float rstd = 1.f / sqrtf(wave_sum(s) * (1.f / D) + RMS_EPS);
            GAS unsigned long long* o8 = (GAS unsigned long long*)(dst + (size_t)(row0 + r) * D) + F.lane;
#pragma unroll
            for (int j = 0; j < 4; ++j) { const f32x4 o = v[j] * rstd * A[j] + B[j];
                o8[64 * j] = (unsigned long long)pk2(o.x, o.y) | ((unsigned long long)pk2(o.z, o.w) << 32); }
        }
    }
}
__device__ __forceinline__ void finalnorm_phase(Frame& F, float* io, const float* g) {
    const int gw = F.vcu * NWAVES + F.wave, NGW = F.G * NWAVES;
    f32x4 A[4];
#pragma unroll
    for (int j = 0; j < 4; ++j) A[j] = *(const f32x4*)(g + 4 * F.lane + 256 * j);
    for (int row = gw; row < M; row += NGW) {
        GAS f32x4* xr = (GAS f32x4*)(io + (size_t)row * D) + F.lane;
        f32x4 v[4]; float s = 0.f;
#pragma unroll
        for (int j = 0; j < 4; ++j) { v[j] = xr[64 * j]; s += (v[j].x * v[j].x + v[j].y * v[j].y) + (v[j].z * v[j].z + v[j].w * v[j].w); }
        const float rstd = 1.f / sqrtf(wave_sum(s) * (1.f / D) + RMS_EPS);
#pragma unroll
        for (int j = 0; j < 4; ++j) xr[64 * j] = v[j] * rstd * A[j];
    }
}
__device__ __forceinline__ void kmean_phase(Frame& F) {
    LAS float* red = (LAS float*)(F.lds + RING_OFF);
    const bf16* Kb = (const bf16*)(F.ws + WS_K); float* km = (float*)(F.ws + WS_KMEAN);
    for (int u = F.vcu; u < BATCH * NBLK * NH; u += F.G) {
        const int b = u >> 8, blk = (u >> 3) & 31, h = u & 7;
        const int c8 = F.tid & 7, rg = F.tid >> 3;
        float s[8] = {0.f, 0.f, 0.f, 0.f, 0.f, 0.f, 0.f, 0.f};
#pragma unroll
        for (int i = 0; i < 4; ++i) { const v4u w = *(const GAS v4u*)(Kb + (size_t)(b * SEQ + blk * BLK + rg * 4 + i) * AW + h * HD + c8 * 8);
            s[0] += bflo(w.x); s[1] += bfhi(w.x); s[2] += bflo(w.y); s[3] += bfhi(w.y); s[4] += bflo(w.z); s[5] += bfhi(w.z); s[6] += bflo(w.w); s[7] += bfhi(w.w); }
#pragma unroll
        for (int e = 0; e < 8; ++e) red[rg * 64 + c8 * 8 + e] = s[e];
        __syncthreads();
        if (F.tid < 64) { float t = 0.f; for (int r = 0; r < 64; ++r) t += red[r * 64 + F.tid]; km[(size_t)(b * NBLK + blk) * AW + h * HD + F.tid] = t * (1.f / 256.f); }
        __syncthreads();
    }
}
__device__ __forceinline__ void gating_phase(Frame& F) {
    LAS float* kml = (LAS float*)(F.lds + RING_OFF);
    LAS unsigned* wcnt = (LAS unsigned*)(F.lds + RING_OFF + 8192);
    const bf16* Qb = (const bf16*)(F.ws + WS_Q); const float* km = (const float*)(F.ws + WS_KMEAN);
    unsigned* cnt = (unsigned*)(F.ws + WS_CNT); unsigned short* lbuf = (unsigned short*)(F.ws + WS_LBUF);
    for (int u = F.vcu; u < 32 * 32; u += F.G) {
        const int bh = u >> 5, bq = u & 31, b = bh >> 3, h = bh & 7;
        for (int i = F.tid; i < bq * 64; i += 512) kml[i] = km[(size_t)(b * NBLK + (i >> 6)) * AW + h * HD + (i & 63)];
        if (F.tid < 128) wcnt[F.tid] = 0u;
        __syncthreads();
        int i1 = -1, i2 = -1, i3 = -1;
        if (F.tid < 256 && bq > 0) {
            const int t = bq * BLK + F.tid;
            float q[64];
            const GAS v4u* qp = (const GAS v4u*)(Qb + (size_t)(b * SEQ + t) * AW + h * HD);
#pragma unroll
            for (int c = 0; c < 8; ++c) { const v4u w = qp[c]; q[8 * c] = bflo(w.x); q[8 * c + 1] = bfhi(w.x); q[8 * c + 2] = bflo(w.y); q[8 * c + 3] = bfhi(w.y); q[8 * c + 4] = bflo(w.z); q[8 * c + 5] = bfhi(w.z); q[8 * c + 6] = bflo(w.w); q[8 * c + 7] = bfhi(w.w); }
            float v1 = -3.0e38f, v2 = -3.0e38f, v3 = -3.0e38f;
            for (int j = 0; j < bq; ++j) {
                const LAS f32x4* kp = (const LAS f32x4*)(kml + j * 64);
                float g0 = 0.f, g1 = 0.f, g2 = 0.f, g3 = 0.f;
#pragma unroll
                for (int c = 0; c < 16; ++c) { const f32x4 kk = kp[c]; g0 += q[4 * c] * kk.x; g1 += q[4 * c + 1] * kk.y; g2 += q[4 * c + 2] * kk.z; g3 += q[4 * c + 3] * kk.w; }
                const float g = (g0 + g1) + (g2 + g3);
                if (g > v1) { v3 = v2; i3 = i2; v2 = v1; i2 = i1; v1 = g; i1 = j; }
                else if (g > v2) { v3 = v2; i3 = i2; v2 = g; i2 = j; }
                else if (g > v3) { v3 = g; i3 = j; }
            }
        }
        if (F.wave < 4) {
            for (int j = 0; j < bq; ++j) { const bool has = (i1 == j) || (i2 == j) || (i3 == j); const unsigned long long mk = __ballot(has);
                if (F.lane == 0) wcnt[j * 4 + F.wave] = (unsigned)__popcll(mk); }
        }
        __syncthreads();
        if (F.wave < 4) {
            const unsigned long long lt = (1ull << F.lane) - 1ull;
            for (int j = 0; j < bq; ++j) { const bool has = (i1 == j) || (i2 == j) || (i3 == j); const unsigned long long mk = __ballot(has);
                if (has) { unsigned base = 0; for (int w = 0; w < F.wave; ++w) base += wcnt[j * 4 + w];
                    const unsigned pos = base + (unsigned)__popcll(mk & lt); const unsigned rank = (i1 == j) ? 0u : ((i2 == j) ? 1u : 2u);
                    lbuf[((size_t)(bh * 32 + bq) * 32 + j) * 256 + pos] = (unsigned short)((unsigned)(bq * BLK + F.tid) | (rank << 13)); } }
        }
        if (F.tid < 32) cnt[(bh * 32 + bq) * 32 + F.tid] = (F.tid < bq) ? (wcnt[F.tid * 4] + wcnt[F.tid * 4 + 1] + wcnt[F.tid * 4 + 2] + wcnt[F.tid * 4 + 3]) : 0u;
        __syncthreads();
    }
}
__device__ __forceinline__ void compact_phase(Frame& F) {
    LAS unsigned* cs = (LAS unsigned*)(F.lds + RING_OFF);
    const unsigned* cnt = (const unsigned*)(F.ws + WS_CNT); const unsigned short* lbuf = (const unsigned short*)(F.ws + WS_LBUF);
    unsigned short* gl = (unsigned short*)(F.ws + WS_GLIST); unsigned* tot = (unsigned*)(F.ws + WS_TOT);
    for (int u = F.vcu; u < 32 * 32; u += F.G) {
        const int bh = u >> 5, j = u & 31;
        if (F.tid < 32) cs[F.tid] = (F.tid > j) ? cnt[(bh * 32 + F.tid) * 32 + j] : 0u;
        __syncthreads();
        if (F.tid == 0) { unsigned o = 0; for (int i = 0; i < 32; ++i) { cs[32 + i] = o; o += cs[i]; } tot[bh * 32 + j] = o; }
        __syncthreads();
        for (int bq = j + 1 + (F.tid >> 8); bq < 32; bq += 2) { const unsigned c = cs[bq], o = cs[32 + bq]; const int i = F.tid & 255;
            if ((unsigned)i < c) gl[(size_t)(bh * 32 + j) * 8192 + o + i] = lbuf[((size_t)(bh * 32 + bq) * 32 + j) * 256 + i]; }
        __syncthreads();
    }
}

constexpr int AL_K = 0, AL_V = 32768, AL_WS = 65536, AL_ST = 69632, AL_TAB = 102400;
__device__ __forceinline__ int crow(int r, int hi) { return (r & 3) + 8 * (r >> 2) + 4 * hi; }
__device__ __forceinline__ void glds16(const void* gsrc, unsigned lds_dst) { unsigned keep;
    asm volatile("s_mov_b32 %0, m0\n\ts_mov_b32 m0, %2\n\ts_nop 0\n\tglobal_load_lds_dwordx4 %1, off\n\ts_mov_b32 m0, %0" : "=&s"(keep) : "v"(gsrc), "s"(lds_dst) : "memory"); }
typedef float f32x2_t __attribute__((ext_vector_type(2))); typedef __bf16 bf16x2_t __attribute__((ext_vector_type(2)));
__device__ __forceinline__ unsigned cvtpk_s(float lo, float hi) { f32x2_t v = {lo, hi}; bf16x2_t b = __builtin_convertvector(v, bf16x2_t); return __builtin_bit_cast(unsigned, b); }
typedef short v4i16_t __attribute__((ext_vector_type(4)));
__device__ __forceinline__ s16x4 vtr(const LAS char* p) { return __builtin_bit_cast(s16x4, __builtin_amdgcn_ds_read_tr16_b64_v4i16((LAS v4i16_t*)p)); }

template <bool OWN>
__device__ __forceinline__ void attn_tile(Frame& F, int b, int h, int kb, int tq, bool valid, int rank, int nv) {
    const int lane = F.lane, wid = F.wave, r32 = lane & 31, hi = lane >> 5;
    const int bh = b * NH + h;
    const bf16* Qb = (const bf16*)(F.ws + WS_Q); const bf16* Kb = (const bf16*)(F.ws + WS_K); const bf16* Vb = (const bf16*)(F.ws + WS_V);
    const bf16* Kh = Kb + (size_t)(b * SEQ + kb * BLK) * AW + h * HD; const bf16* Vh = Vb + (size_t)(b * SEQ + kb * BLK) * AW + h * HD;
    const unsigned lds0 = (unsigned)(uintptr_t)(F.lds + RING_OFF);
    {
        const bf16* ksrc = Kh + (size_t)lane * AW + wid * 8;
        const bf16* vsrc = Vh + (size_t)(16 * (wid & 3) + (lane >> 2)) * AW + (wid >> 2) * 32 + (lane & 3) * 8;
#pragma unroll
        for (int c4 = 0; c4 < 4; ++c4) {
            glds16(ksrc + (size_t)c4 * 64 * AW, (unsigned)__builtin_amdgcn_readfirstlane(lds0 + AL_K + c4 * 8192 + wid * 1024));
            glds16(vsrc + (size_t)c4 * 64 * AW, (unsigned)__builtin_amdgcn_readfirstlane(lds0 + AL_V + c4 * 8192 + wid * 1024));
        }
    }
    bf16x8 qr[4];
    { const bf16* qp = Qb + (size_t)(b * SEQ + tq) * AW + h * HD + hi * 8;
#pragma unroll
      for (int d0 = 0; d0 < 4; ++d0) qr[d0] = *(const GAS bf16x8*)(qp + d0 * 16); }
    asm volatile("s_waitcnt vmcnt(0)" ::: "memory");
    __syncthreads();
    const float slope2 = __builtin_amdgcn_exp2f(-(float)(h + 1)) * LOG2E;
    const LAS char* kbase = (const LAS char*)(F.lds + RING_OFF + AL_K) + hi * 1024 + r32 * 16;
    const LAS char* vbase = (const LAS char*)(F.lds + RING_OFF + AL_V) + ((lane >> 4) & 1) * 32 + (lane & 3) * 8 + (4 * hi + ((lane & 15) >> 2)) * 64;
    LAS float* wsf = (LAS float*)(F.lds + RING_OFF + AL_WS) + wid * 128;
    const int qloc = OWN ? (tq & 255) : 0;
    const float dq = (float)(kb * BLK - tq);
    float mx = -INFINITY, lsum = 0.f;
    f32x16 o[2]; o[0] = f32x16{}; o[1] = f32x16{};
    float ab[16];
#pragma unroll
    for (int r = 0; r < 16; ++r) ab[r] = slope2 * (float)crow(r, hi);
#pragma unroll 1
    for (int c4 = 0; c4 < 4; ++c4) {
        if (OWN && (64 * c4 > 32 * wid + 31)) continue;
        f32x16 s[2];
#pragma unroll
        for (int p = 0; p < 2; ++p) {
            const int k0 = 64 * c4 + 32 * p;
            f32x16 acc;
            if (OWN && (k0 > 32 * wid + 31)) {
#pragma unroll
                for (int r = 0; r < 16; ++r) acc[r] = -INFINITY;
            } else {
                const float sc_ = slope2 * (dq + (float)k0);
#pragma unroll
                for (int r = 0; r < 16; ++r) acc[r] = ab[r] + sc_;
#pragma unroll
                for (int d0 = 0; d0 < 4; ++d0) { const bf16x8 kf = *(const LAS bf16x8*)(kbase + c4 * 8192 + d0 * 2048 + p * 512);
                    acc = __builtin_amdgcn_mfma_f32_32x32x16_bf16(kf, qr[d0], acc, 0, 0, 0); }
                if (OWN) {
#pragma unroll
                    for (int r = 0; r < 16; ++r) if (k0 + crow(r, hi) > qloc) acc[r] = -INFINITY;
                }
            }
            s[p] = acc;
        }
        float mt = -INFINITY;
#pragma unroll
        for (int r = 0; r < 16; ++r) mt = fmaxf(mt, fmaxf(s[0][r], s[1][r]));
        { auto rr = __builtin_amdgcn_permlane32_swap(__float_as_uint(mt), __float_as_uint(mt), false, false); mt = fmaxf(__uint_as_float(rr[0]), __uint_as_float(rr[1])); }
        const float mnew = fmaxf(mx, mt);
        const float alpha = __builtin_amdgcn_exp2f(mx - mnew);
        mx = mnew;
        float ls = 0.f;
#pragma unroll
        for (int p = 0; p < 2; ++p)
#pragma unroll
            for (int r = 0; r < 16; ++r) { s[p][r] = __builtin_amdgcn_exp2f(s[p][r] - mnew); ls += s[p][r]; }
        lsum = lsum * alpha + ls;
        if (hi == 0) wsf[r32] = alpha;
        LDS_WAIT(); asm volatile("" ::: "memory");
#pragma unroll
        for (int r = 0; r < 16; ++r) { const float f = wsf[crow(r, hi)]; o[0][r] *= f; o[1][r] *= f; }
        const v4u a0 = {cvtpk_s(s[0][0], s[0][1]), cvtpk_s(s[0][2], s[0][3]), cvtpk_s(s[0][4], s[0][5]), cvtpk_s(s[0][6], s[0][7])};
        const v4u a1 = {cvtpk_s(s[0][8], s[0][9]), cvtpk_s(s[0][10], s[0][11]), cvtpk_s(s[0][12], s[0][13]), cvtpk_s(s[0][14], s[0][15])};
        const v4u a2 = {cvtpk_s(s[1][0], s[1][1]), cvtpk_s(s[1][2], s[1][3]), cvtpk_s(s[1][4], s[1][5]), cvtpk_s(s[1][6], s[1][7])};
        const v4u a3 = {cvtpk_s(s[1][8], s[1][9]), cvtpk_s(s[1][10], s[1][11]), cvtpk_s(s[1][12], s[1][13]), cvtpk_s(s[1][14], s[1][15])};
#pragma unroll
        for (int d0 = 0; d0 < 2; ++d0) {
            s16x4 lo[4], hh[4];
#pragma unroll
            for (int ks = 0; ks < 4; ++ks) { lo[ks] = vtr(vbase + c4 * 8192 + d0 * 4096 + ks * 1024); hh[ks] = vtr(vbase + c4 * 8192 + d0 * 4096 + ks * 1024 + 512); }
#define PKV(k) (bf16x8){lo[k][0], lo[k][1], lo[k][2], lo[k][3], hh[k][0], hh[k][1], hh[k][2], hh[k][3]}
            o[d0] = __builtin_amdgcn_mfma_f32_32x32x16_bf16(__builtin_bit_cast(bf16x8, a0), PKV(0), o[d0], 0, 0, 0);
            o[d0] = __builtin_amdgcn_mfma_f32_32x32x16_bf16(__builtin_bit_cast(bf16x8, a1), PKV(1), o[d0], 0, 0, 0);
            o[d0] = __builtin_amdgcn_mfma_f32_32x32x16_bf16(__builtin_bit_cast(bf16x8, a2), PKV(2), o[d0], 0, 0, 0);
            o[d0] = __builtin_amdgcn_mfma_f32_32x32x16_bf16(__builtin_bit_cast(bf16x8, a3), PKV(3), o[d0], 0, 0, 0);
#undef PKV
        }
    }
    { auto rr = __builtin_amdgcn_permlane32_swap(__float_as_uint(lsum), __float_as_uint(lsum), false, false); lsum = __uint_as_float(rr[0]) + __uint_as_float(rr[1]); }
    LAS int* wsi = (LAS int*)wsf;
    LAS bf16* stg = (LAS bf16*)(F.lds + RING_OFF + AL_ST) + wid * 2048;
    if (hi == 0) { wsf[r32] = lsum; wsf[32 + r32] = mx; wsi[64 + r32] = valid ? (OWN ? tq : ((bh * SEQ + tq) * 3 + rank)) : -1; }
    LDS_WAIT(); asm volatile("" ::: "memory");
    float rli[16];
#pragma unroll
    for (int r = 0; r < 16; ++r) rli[r] = __builtin_amdgcn_rcpf(wsf[crow(r, hi)]);
#pragma unroll
    for (int r = 0; r < 16; ++r) { const int orow = crow(r, hi);
#pragma unroll
        for (int d0 = 0; d0 < 2; ++d0) stg[orow * 64 + d0 * 32 + r32] = (bf16)f2bf(o[d0][r] * rli[r]); }
    LDS_WAIT(); asm volatile("" ::: "memory");
    float* pml = (float*)(F.ws + WS_PML); bf16* po = (bf16*)(F.ws + WS_PO);
    if (!OWN) {
        if (hi == 0 && valid) { const size_t di = (size_t)(bh * SEQ + tq) * 3 + rank; pml[di * 2] = mx; pml[di * 2 + 1] = lsum; }
#pragma unroll
        for (int i = 0; i < 4; ++i) { const int row = i * 8 + (lane >> 3), ch = lane & 7; const int di = wsi[64 + row];
            const v4u v = *(const LAS v4u*)(stg + row * 64 + ch * 8);
            if (di >= 0) *(GAS v4u*)(po + (size_t)di * 64 + ch * 8) = v; }
    } else {
        bf16* att = (bf16*)(F.ws + WS_ATT); float* ssb = (float*)(F.ws + WS_SS);
#pragma unroll
        for (int i = 0; i < 4; ++i) { const int row = i * 8 + (lane >> 3), ch = lane & 7; const int t = wsi[64 + row];
            const v4u v = *(const LAS v4u*)(stg + row * 64 + ch * 8);
            const float mo = wsf[32 + row], lo_ = wsf[row];
            float pm_[3], pl_[3]; float Mx = mo;
#pragma unroll
            for (int k = 0; k < 3; ++k) { if (k < nv) { const size_t di = (size_t)(bh * SEQ + t) * 3 + k; pm_[k] = pml[di * 2]; pl_[k] = pml[di * 2 + 1]; Mx = fmaxf(Mx, pm_[k]); } else { pm_[k] = -INFINITY; pl_[k] = 0.f; } }
            float w0 = lo_ * __builtin_amdgcn_exp2f(mo - Mx); float wsum = w0;
            float a[8] = {bflo(v.x) * w0, bfhi(v.x) * w0, bflo(v.y) * w0, bfhi(v.y) * w0, bflo(v.z) * w0, bfhi(v.z) * w0, bflo(v.w) * w0, bfhi(v.w) * w0};
#pragma unroll
            for (int k = 0; k < 3; ++k) if (k < nv) { const float wk = pl_[k] * __builtin_amdgcn_exp2f(pm_[k] - Mx); wsum += wk;
                const v4u pv = *(const GAS v4u*)(po + ((size_t)(bh * SEQ + t) * 3 + k) * 64 + ch * 8);
                a[0] += bflo(pv.x) * wk; a[1] += bfhi(pv.x) * wk; a[2] += bflo(pv.y) * wk; a[3] += bfhi(pv.y) * wk; a[4] += bflo(pv.z) * wk; a[5] += bfhi(pv.z) * wk; a[6] += bflo(pv.w) * wk; a[7] += bfhi(pv.w) * wk; }
            const float inv = 1.f / wsum; float ss = 0.f;
#pragma unroll
            for (int e = 0; e < 8; ++e) { a[e] *= inv; ss += a[e] * a[e]; }
            ss += __shfl_xor(ss, 1); ss += __shfl_xor(ss, 2); ss += __shfl_xor(ss, 4);
            v4u ov; ov.x = pk2(a[0], a[1]); ov.y = pk2(a[2], a[3]); ov.z = pk2(a[4], a[5]); ov.w = pk2(a[6], a[7]);
            *(GAS v4u*)(att + (size_t)(b * SEQ + t) * AW + h * HD + ch * 8) = ov;
            if (ch == 0) ssb[(size_t)(b * SEQ + t) * NH + h] = ss; }
    }
    __syncthreads();
}
__device__ __forceinline__ void seltile_phase(Frame& F) {
    LAS unsigned* pre = (LAS unsigned*)(F.lds + RING_OFF + AL_TAB);
    LAS unsigned* tl = pre + 1032;
    LAS unsigned* wt = tl + 1024;
    const unsigned* tot = (const unsigned*)(F.ws + WS_TOT); const unsigned short* gl = (const unsigned short*)(F.ws + WS_GLIST);
    { const unsigned t0 = tot[2 * F.tid], t1 = tot[2 * F.tid + 1]; tl[2 * F.tid] = t0; tl[2 * F.tid + 1] = t1;
      const unsigned n0 = (t0 + 255u) >> 8, n1 = (t1 + 255u) >> 8; unsigned s = n0 + n1;
#pragma unroll
      for (int o = 1; o < 64; o <<= 1) { const unsigned v = __shfl_up(s, o); if (F.lane >= o) s += v; }
      if (F.lane == 63) wt[F.wave] = s;
      __syncthreads();
      unsigned base = 0; for (int w = 0; w < F.wave; ++w) base += wt[w];
      const unsigned ex = base + s - (n0 + n1); pre[2 * F.tid] = ex; pre[2 * F.tid + 1] = ex + n0;
      if (F.tid == 511) pre[1024] = ex + n0 + n1;
      __syncthreads(); }
    const unsigned ntiles = pre[1024];
    for (unsigned n = (unsigned)F.vcu; n < ntiles; n += (unsigned)F.G) {
        int lo = 0, hi_ = 1024;
        while (hi_ - lo > 1) { const int mid = (lo + hi_) >> 1; if (pre[mid] <= n) lo = mid; else hi_ = mid; }
        const int e = lo; const unsigned c = n - pre[e]; const unsigned total = tl[e];
        const int bh = e >> 5, j = e & 31;
        const unsigned r = c * 256u + (unsigned)(F.wave * 32 + (F.lane & 31));
        const bool valid = r < total;
        unsigned ent = 0; if (valid) ent = gl[(size_t)e * 8192 + r];
        const int tq = valid ? (int)(ent & 8191u) : (j + 1) * BLK;
        attn_tile<false>(F, bh >> 3, bh & 7, j, tq, valid, (int)(ent >> 13), 0);
    }
}
__device__ __forceinline__ void owntile_phase(Frame& F) {
    for (int u = F.vcu; u < 32 * 32; u += F.G) {
        const int bh = u >> 5, bq = u & 31;
        const int tq = bq * BLK + F.wave * 32 + (F.lane & 31);
        attn_tile<true>(F, bh >> 3, bh & 7, bq, tq, true, 0, bq < 3 ? bq : 3);
    }
}
__device__ __forceinline__ void mix_phase(Frame& F) {
    const int gw = F.vcu * NWAVES + F.wave, NGW = F.G * NWAVES, l = F.lane;
    const bf16* att = (const bf16*)(F.ws + WS_ATT); const float* ssb = (const float*)(F.ws + WS_SS);
    const bf16* U = (const bf16*)(F.ws + WS_U); const bf16* CG = (const bf16*)(F.ws + WS_CG); const bf16* BG = (const bf16*)(F.ws + WS_BG);
    bf16* mix = (bf16*)(F.ws + WS_MIX);
    const float* cw = F.in[6]; const float* cb = F.in[7]; const float* ga = F.in[8]; const float* gc = F.in[9];
    float w0[8], w1[8], w2[8], bb[8], gav[8], gcv[8];
#pragma unroll
    for (int e = 0; e < 8; ++e) { w0[e] = cw[8 * l + e]; w1[e] = cw[512 + 8 * l + e]; w2[e] = cw[1024 + 8 * l + e]; bb[e] = cb[8 * l + e]; gav[e] = ga[8 * l + e]; gcv[e] = gc[8 * l + e]; }
    for (int ch = gw; ch < M / 16; ch += NGW) {
        const int row0 = ch * 16; const int ts0 = row0 & (SEQ - 1);
        float z1[8], z2[8];
#pragma unroll
        for (int e = 0; e < 8; ++e) { z1[e] = 0.f; z2[e] = 0.f; }
        if (ts0 >= 1) { const v4u a = *(const GAS v4u*)(U + (size_t)(row0 - 1) * AW + 8 * l), c = *(const GAS v4u*)(CG + (size_t)(row0 - 1) * AW + 8 * l);
            z1[0] = bflo(a.x) * bflo(c.x); z1[1] = bfhi(a.x) * bfhi(c.x); z1[2] = bflo(a.y) * bflo(c.y); z1[3] = bfhi(a.y) * bfhi(c.y); z1[4] = bflo(a.z) * bflo(c.z); z1[5] = bfhi(a.z) * bfhi(c.z); z1[6] = bflo(a.w) * bflo(c.w); z1[7] = bfhi(a.w) * bfhi(c.w); }
        if (ts0 >= 2) { const v4u a = *(const GAS v4u*)(U + (size_t)(row0 - 2) * AW + 8 * l), c = *(const GAS v4u*)(CG + (size_t)(row0 - 2) * AW + 8 * l);
            z2[0] = bflo(a.x) * bflo(c.x); z2[1] = bfhi(a.x) * bfhi(c.x); z2[2] = bflo(a.y) * bflo(c.y); z2[3] = bfhi(a.y) * bfhi(c.y); z2[4] = bflo(a.z) * bflo(c.z); z2[5] = bfhi(a.z) * bfhi(c.z); z2[6] = bflo(a.w) * bflo(c.w); z2[7] = bfhi(a.w) * bfhi(c.w); }
        for (int r = 0; r < 16; ++r) {
            const size_t row = (size_t)(row0 + r);
            { const v4u a = *(const GAS v4u*)(att + row * AW + 8 * l); const f32x4 s0 = *(const GAS f32x4*)(ssb + row * NH), s1 = *(const GAS f32x4*)(ssb + row * NH + 4);
              const float ss = ((s0.x + s0.y) + (s0.z + s0.w)) + ((s1.x + s1.y) + (s1.z + s1.w));
              const float rs = 1.f / sqrtf(ss * (1.f / AW) + RMS_EPS);
              v4u o; o.x = pk2(bflo(a.x) * rs * gav[0], bfhi(a.x) * rs * gav[1]); o.y = pk2(bflo(a.y) * rs * gav[2], bfhi(a.y) * rs * gav[3]);
              o.z = pk2(bflo(a.z) * rs * gav[4], bfhi(a.z) * rs * gav[5]); o.w = pk2(bflo(a.w) * rs * gav[6], bfhi(a.w) * rs * gav[7]);
              *(GAS v4u*)(mix + row * D + 8 * l) = o; }
            { const v4u a = *(const GAS v4u*)(U + row * AW + 8 * l), c = *(const GAS v4u*)(CG + row * AW + 8 * l), g = *(const GAS v4u*)(BG + row * AW + 8 * l);
              float z0[8] = {bflo(a.x) * bflo(c.x), bfhi(a.x) * bfhi(c.x), bflo(a.y) * bflo(c.y), bfhi(a.y) * bfhi(c.y), bflo(a.z) * bflo(c.z), bfhi(a.z) * bfhi(c.z), bflo(a.w) * bflo(c.w), bfhi(a.w) * bfhi(c.w)};
              const float gg[8] = {bflo(g.x), bfhi(g.x), bflo(g.y), bfhi(g.y), bflo(g.z), bfhi(g.z), bflo(g.w), bfhi(g.w)};
              float v[8]; float ss = 0.f;
#pragma unroll
              for (int e = 0; e < 8; ++e) { v[e] = gg[e] * (w0[e] * z2[e] + w1[e] * z1[e] + w2[e] * z0[e] + bb[e]); ss += v[e] * v[e]; z2[e] = z1[e]; z1[e] = z0[e]; }
              const float rs = 1.f / sqrtf(wave_sum(ss) * (1.f / AW) + RMS_EPS);
              v4u o; o.x = pk2(v[0] * rs * gcv[0], v[1] * rs * gcv[1]); o.y = pk2(v[2] * rs * gcv[2], v[3] * rs * gcv[3]); o.z = pk2(v[4] * rs * gcv[4], v[5] * rs * gcv[5]); o.w = pk2(v[6] * rs * gcv[6], v[7] * rs * gcv[7]);
              *(GAS v4u*)(mix + row * D + AW + 8 * l) = o; }
        }
    }
}
__device__ __forceinline__ void act_phase(Frame& F, int half) {
    const bf16* up = (const bf16*)(F.ws + WS_UPH); bf16* act = (bf16*)(F.ws + WS_ACT) + (size_t)half * (M / 2) * DFF;
    const float* cw = F.in[13]; const float* cb = F.in[14];
    const int gt = F.vcu * 512 + F.tid, NGT = F.G * 512;
    constexpr int NC8 = DFF / 8, NSEG = (M / 2) / 16;
    for (int it = gt; it < NSEG * NC8; it += NGT) {
        const int c8 = it % NC8, seg = it / NC8; const int c = c8 * 8, row0 = seg * 16; const int ts0 = row0 & (SEQ - 1);
        float wv[3][8], wg[3][8], bv[8], bg[8];
#pragma unroll
        for (int k = 0; k < 3; ++k)
#pragma unroll
            for (int e = 0; e < 8; ++e) { wv[k][e] = cw[k * NUP + c + e]; wg[k][e] = cw[k * NUP + DFF + c + e]; }
#pragma unroll
        for (int e = 0; e < 8; ++e) { bv[e] = cb[c + e]; bg[e] = cb[DFF + c + e]; }
        float v1[8], v2[8], g1[8], g2[8];
#pragma unroll
        for (int e = 0; e < 8; ++e) { v1[e] = 0.f; v2[e] = 0.f; g1[e] = 0.f; g2[e] = 0.f; }
        if (ts0 >= 1) { const v4u a = *(const GAS v4u*)(up + (size_t)(row0 - 1) * NUP + c), g = *(const GAS v4u*)(up + (size_t)(row0 - 1) * NUP + DFF + c);
            v1[0] = bflo(a.x); v1[1] = bfhi(a.x); v1[2] = bflo(a.y); v1[3] = bfhi(a.y); v1[4] = bflo(a.z); v1[5] = bfhi(a.z); v1[6] = bflo(a.w); v1[7] = bfhi(a.w);
            g1[0] = bflo(g.x); g1[1] = bfhi(g.x); g1[2] = bflo(g.y); g1[3] = bfhi(g.y); g1[4] = bflo(g.z); g1[5] = bfhi(g.z); g1[6] = bflo(g.w); g1[7] = bfhi(g.w); }
        if (ts0 >= 2) { const v4u a = *(const GAS v4u*)(up + (size_t)(row0 - 2) * NUP + c), g = *(const GAS v4u*)(up + (size_t)(row0 - 2) * NUP + DFF + c);
            v2[0] = bflo(a.x); v2[1] = bfhi(a.x); v2[2] = bflo(a.y); v2[3] = bfhi(a.y); v2[4] = bflo(a.z); v2[5] = bfhi(a.z); v2[6] = bflo(a.w); v2[7] = bfhi(a.w);
            g2[0] = bflo(g.x); g2[1] = bfhi(g.x); g2[2] = bflo(g.y); g2[3] = bfhi(g.y); g2[4] = bflo(g.z); g2[5] = bfhi(g.z); g2[6] = bflo(g.w); g2[7] = bfhi(g.w); }
        for (int r = 0; r < 16; ++r) {
            const size_t row = (size_t)(row0 + r);
            const v4u a = *(const GAS v4u*)(up + row * NUP + c), g = *(const GAS v4u*)(up + row * NUP + DFF + c);
            const float v0[8] = {bflo(a.x), bfhi(a.x), bflo(a.y), bfhi(a.y), bflo(a.z), bfhi(a.z), bflo(a.w), bfhi(a.w)};
            const float g0[8] = {bflo(g.x), bfhi(g.x), bflo(g.y), bfhi(g.y), bflo(g.z), bfhi(g.z), bflo(g.w), bfhi(g.w)};
            float o[8];
#pragma unroll
            for (int e = 0; e < 8; ++e) { const float cv = wv[0][e] * v2[e] + wv[1][e] * v1[e] + wv[2][e] * v0[e] + bv[e]; const float cg = wg[0][e] * g2[e] + wg[1][e] * g1[e] + wg[2][e] * g0[e] + bg[e];
                o[e] = cv * cg / (1.f + __expf(-cg)); v2[e] = v1[e]; v1[e] = v0[e]; g2[e] = g1[e]; g1[e] = g0[e]; }
            v4u ov; ov.x = pk2(o[0], o[1]); ov.y = pk2(o[2], o[3]); ov.z = pk2(o[4], o[5]); ov.w = pk2(o[6], o[7]);
            *(GAS v4u*)(act + row * DFF + c) = ov;
        }
    }
}

struct Args { const float* in[17]; float* out; unsigned char* ws; int ph_lo, ph_hi, use_bar, pad; };
__global__ void __launch_bounds__(NWAVES * 64, 2) hyb_fwd(Args args) {
    extern __shared__ __attribute__((aligned(16))) unsigned char lds[];
    Frame F;
    F.lds = (LAS unsigned char*)lds;
    F.MISC = (volatile LAS unsigned*)(F.lds + MISC_OFF);
    F.tid = threadIdx.x; F.lane = F.tid & 63; F.wave = __builtin_amdgcn_readfirstlane(F.tid >> 6);
    F.G = gridDim.x; { const int bx = blockIdx.x; F.vcu = (F.G % 8 == 0) ? (bx % 8) * (F.G / 8) + bx / 8 : bx; }
    F.ws = args.ws; F.ctl = (gu32*)(args.ws + WS_CTL); F.out = args.out;
#pragma unroll
    for (int i = 0; i < 17; ++i) F.in[i] = args.in[i];
    for (int u = F.tid; u < (LDS_BYTES - LDSCTL_OFF) / 4; u += NWAVES * 64) ((LAS unsigned*)(F.lds + LDSCTL_OFF))[u] = 0u;
    __syncthreads();
    XcdBarrier bar; bar.bar = (unsigned*)(F.ctl + CW_BAR); bar.x = 0; bar.st = nullptr;
    if (args.use_bar) bar = xcd_barrier_post((unsigned*)(F.ctl + CW_BAR), F.MISC + 8);
    const int lo = args.ph_lo, hi = args.ph_hi;
#define IN(k) (lo <= (k) && (k) < hi)
#define SEAM(k) do { if (IN(k) && IN((k) + 1)) xcd_barrier(bar); } while (0)
    const float* mod = (const float*)(F.ws + WS_MOD);

    if (IN(0)) { p0_prologue(F); } SEAM(0);
    if (IN(1)) { modnorm_phase(F, F.in[0], F.in[4], 0, 1024, (bf16*)(F.ws + WS_XN)); } SEAM(1);
    if (IN(2)) { pg8::Gemm g{(const bf16*)(F.ws + WS_XN), (const bf16*)(F.ws + WS_WIN), M, NIN, D}; pg8::StaticOrder S; S.init(M, NIN, F.G, (int)blockIdx.x);
        pg8::EpiBf16 E{(bf16*)(F.ws + WS_Q), AW, AW, (size_t)(WS_K - WS_Q) / 2, C2};
        pg8::gemm_phase<pg8::EpiBf16, pg8::StaticOrder, true, true>(F.lds + RING_OFF, g, S, E); } SEAM(2);
    if (IN(3)) { kmean_phase(F); } SEAM(3);
    if (IN(4)) { gating_phase(F); } SEAM(4);
    if (IN(5)) { compact_phase(F); } SEAM(5);
    if (IN(6)) { seltile_phase(F); } SEAM(6);
    if (IN(7)) { owntile_phase(F); } SEAM(7);
    if (IN(8)) { mix_phase(F); } SEAM(8);
    if (IN(9)) { pg8::Gemm g{(const bf16*)(F.ws + WS_MIX), (const bf16*)(F.ws + WS_WOUT), M, D, D}; pg8::StaticOrder S; S.init(M, D, F.G, (int)blockIdx.x);
        pg8::EpiRes E{F.in[0], F.out, mod + 2048, D};
        pg8::gemm_phase<pg8::EpiRes, pg8::StaticOrder, true, true>(F.lds + RING_OFF, g, S, E); } SEAM(9);
    if (IN(10)) { modnorm_phase(F, F.out, F.in[11], 3072, 4096, (bf16*)(F.ws + WS_XN)); } SEAM(10);
#pragma unroll 1
    for (int half = 0; half < 2; ++half) {
        if (IN(11 + 2 * half)) { pg8::Gemm g{(const bf16*)(F.ws + WS_XN) + (size_t)half * (M / 2) * D, (const bf16*)(F.ws + WS_WUP), M / 2, NUP, D}; pg8::StaticOrder S; S.init(M / 2, NUP, F.G, (int)blockIdx.x);
            pg8::EpiBf16 E{(bf16*)(F.ws + WS_UPH), NUP, 0, 0, 1.f};
            pg8::gemm_phase<pg8::EpiBf16, pg8::StaticOrder, true, true>(F.lds + RING_OFF, g, S, E); } SEAM(11 + 2 * half);
        if (IN(12 + 2 * half)) { act_phase(F, half); } SEAM(12 + 2 * half);
    }
    if (IN(15)) { pg8::Gemm g{(const bf16*)(F.ws + WS_ACT), (const bf16*)(F.ws + WS_WDN), M, D, DFF}; pg8::StaticOrder S; S.init(M, D, F.G, (int)blockIdx.x);
        pg8::EpiRes E{F.out, F.out, mod + 5120, D};
        pg8::gemm_phase<pg8::EpiRes, pg8::StaticOrder, true, true>(F.lds + RING_OFF, g, S, E); } SEAM(15);
    if (IN(16)) { finalnorm_phase(F, F.out, F.in[16]); }
#undef IN
#undef SEAM
}

extern "C" void kernel_launch(void* const* d_in, const int* in_sizes, int n_in, void* d_out, int out_size, void* d_ws, size_t ws_size, hipStream_t stream) {
    static int grid = 0;
    if (grid == 0) {
        if (n_in != 17 || in_sizes[0] != M * D || out_size != M * D || ws_size < WS_END) { fprintf(stderr, "kernel_launch: shape/workspace mismatch (n_in %d, in0 %d, out %d, ws %zu)\n", n_in, n_in > 0 ? in_sizes[0] : -1, out_size, ws_size); grid = -1; return; }
        int dev = 0, cus = 0, per_cu = 0;
        if (hipGetDevice(&dev) != hipSuccess || hipDeviceGetAttribute(&cus, hipDeviceAttributeMultiprocessorCount, dev) != hipSuccess) { grid = -1; return; }
        if (hipFuncSetAttribute((const void*)hyb_fwd, hipFuncAttributeMaxDynamicSharedMemorySize, LDS_BYTES) != hipSuccess) { fprintf(stderr, "kernel_launch: hipFuncSetAttribute failed\n"); grid = -1; return; }
        if (hipOccupancyMaxActiveBlocksPerMultiprocessor(&per_cu, (const void*)hyb_fwd, NWAVES * 64, LDS_BYTES) != hipSuccess || per_cu < 1)
            fprintf(stderr, "kernel_launch: note: occupancy query reports %d workgroups per CU\n", per_cu);
        (void)hipGetLastError();
        grid = cus;
    }
    if (grid < 0) return;
    if (hipMemsetAsync((char*)d_ws + WS_CTL, 0, CTL_ZERO_BYTES, stream) != hipSuccess) { fprintf(stderr, "kernel_launch: memset failed\n"); return; }
    Args a{};
    for (int i = 0; i < 17; ++i) a.in[i] = (const float*)d_in[i];
    a.out = (float*)d_out; a.ws = (unsigned char*)d_ws;
#if MK_N_LAUNCHES == 1
    a.ph_lo = 0; a.ph_hi = NPHASE; a.use_bar = 1;
    hipLaunchKernelGGL(hyb_fwd, dim3(grid), dim3(NWAVES * 64), LDS_BYTES, stream, a);
#else
    for (int p = 0; p < NPHASE; ++p) { a.ph_lo = p; a.ph_hi = p + 1; a.use_bar = 0;
        hipLaunchKernelGGL(hyb_fwd, dim3(grid), dim3(NWAVES * 64), LDS_BYTES, stream, a); }
#endif
    const hipError_t le = hipPeekAtLastError();
    if (le != hipSuccess) fprintf(stderr, "kernel_launch: launch failed: %s\n", hipGetErrorName(le));
}
```
